# Optimizing an MI355X kernel written in HIP

```python
import math
import jax, jax.numpy as jnp
from jax import lax
import numpy as np

D_MODEL = 1024
BATCH = 4
SEQ = 8192
DEPTH = 1

RET_WIDTH = D_MODEL
RET_HEADS = 8
RET_HEAD_DIM = RET_WIDTH // RET_HEADS
RET_CHUNK = 128
ROPE_BASE = 10000.0
LRU_WIDTH = D_MODEL
LRU_BLOCKS = 8
LRU_BLOCK_DIM = LRU_WIDTH // LRU_BLOCKS
LRU_C = 8.0
CONV_WIDTH = 4
MIX_WIDTH = RET_WIDTH + LRU_WIDTH
IN_SPLITS = (RET_WIDTH, 2 * RET_WIDTH, 3 * RET_WIDTH, 4 * RET_WIDTH, 4 * RET_WIDTH + LRU_WIDTH)
IN_WIDTH = 4 * RET_WIDTH + 2 * LRU_WIDTH
NORM_EPS = 1e-6

kernel_name = "hybrid_retention_rglru_parallel_heads"


def rms_norm(x, g):
    x32 = x.astype(jnp.float32)
    y = x32 * lax.rsqrt(jnp.mean(x32 * x32, axis=-1, keepdims=True) + NORM_EPS)
    return (y * g.astype(jnp.float32)).astype(x.dtype)


def rotary(x):
    T, d = x.shape[1], x.shape[-1]
    inv_freq = ROPE_BASE ** (-jnp.arange(0, d, 2, dtype=jnp.float32) / d)
    ang = jnp.arange(T, dtype=jnp.float32)[:, None] * inv_freq[None, :]
    cos = jnp.cos(ang)[None, :, None, :]
    sin = jnp.sin(ang)[None, :, None, :]
    x1, x2 = x[..., : d // 2], x[..., d // 2:]
    return jnp.concatenate([x1 * cos - x2 * sin, x1 * sin + x2 * cos], axis=-1)


def chunkwise_retention(q, k, v):
    B, T, H, d = q.shape
    C = RET_CHUNK
    nc = T // C
    log_g = jnp.log1p(-jnp.exp2(-5.0 - jnp.arange(H, dtype=jnp.float32)))
    idx = jnp.arange(C, dtype=jnp.float32)
    rel = idx[:, None] - idx[None, :]
    decay_mat = jnp.where(rel[None] >= 0,
                          jnp.exp(jnp.maximum(rel, 0.0)[None] * log_g[:, None, None]), 0.0)
    zeta = jnp.exp((C - 1 - idx)[None, :] * log_g[:, None])
    xi = jnp.exp((idx + 1)[None, :] * log_g[:, None])
    chunk_decay = jnp.exp(C * log_g)

    qc = q.reshape(B, nc, C, H, d)
    kc = k.reshape(B, nc, C, H, d)
    vc = v.reshape(B, nc, C, H, d)

    scores = jnp.einsum('bnqhd,bnkhd->bnhqk', qc, kc) * decay_mat[None, None]
    intra = jnp.einsum('bnhqk,bnkhe->bnqhe', scores, vc)

    kv = jnp.einsum('bnkhd,hk,bnkhe->nbhde', kc, zeta, vc)

    def step(state, kv_n):
        new_state = chunk_decay[None, :, None, None] * state + kv_n
        return new_state, state

    _, prev_states = lax.scan(step, jnp.zeros((B, H, d, d), jnp.float32), kv)
    prev_states = jnp.moveaxis(prev_states, 0, 1)
    cross = jnp.einsum('bnqhd,bnhde->bnqhe', qc, prev_states) * xi.T[None, None, :, :, None]
    return (intra + cross).reshape(B, T, H, d)


def group_norm_heads(o):
    mu = jnp.mean(o, axis=-1, keepdims=True)
    var = jnp.mean(jnp.square(o - mu), axis=-1, keepdims=True)
    return (o - mu) * lax.rsqrt(var + NORM_EPS)


def causal_depthwise_conv(x, w, b):
    T = x.shape[1]
    xp = jnp.pad(x, ((0, 0), (CONV_WIDTH - 1, 0), (0, 0)))
    out = b[None, None, :]
    for j in range(CONV_WIDTH):
        out = out + xp[:, j:j + T, :] * w[j][None, None, :]
    return out


def block_diag_linear(x, w, b):
    B, T, _ = x.shape
    xb = x.reshape(B, T, LRU_BLOCKS, LRU_BLOCK_DIM)
    y = jnp.einsum('btni,nio->btno', xb, w) + b[None, None]
    return y.reshape(B, T, LRU_WIDTH)


def rg_lru(x, gate_a_w, gate_a_b, gate_x_w, gate_x_b, lru_lambda):
    r = jax.nn.sigmoid(block_diag_linear(x, gate_a_w, gate_a_b))
    i = jax.nn.sigmoid(block_diag_linear(x, gate_x_w, gate_x_b))
    log_a = -LRU_C * r * jax.nn.softplus(-lru_lambda)[None, None, :]
    a = jnp.exp(log_a)
    mult = jnp.sqrt(jnp.maximum(1.0 - jnp.exp(2.0 * log_a), 0.0))
    b = mult * (i * x)

    def combine(left, right):
        a_l, b_l = left
        a_r, b_r = right
        return a_l * a_r, a_r * b_l + b_r

    _, h = lax.associative_scan(combine, (a, b), axis=1)
    return h


def setup_inputs(seed: int = 0) -> dict:
    key = jax.random.key(seed)
    ks = jax.random.split(key, 14)
    f32 = jnp.float32
    x = jax.random.normal(ks[0], (BATCH, SEQ, D_MODEL), f32)
    norm_in_g = 1.0 + 0.05 * jax.random.normal(ks[1], (D_MODEL,), f32)
    w_in = jax.random.normal(ks[2], (D_MODEL, IN_WIDTH), f32) * D_MODEL ** -0.5
    conv_w = jax.random.normal(ks[3], (CONV_WIDTH, LRU_WIDTH), f32) * CONV_WIDTH ** -0.5
    conv_b = 0.01 * jax.random.normal(ks[4], (LRU_WIDTH,), f32)
    gate_a_w = jax.random.normal(ks[5], (LRU_BLOCKS, LRU_BLOCK_DIM, LRU_BLOCK_DIM), f32) * LRU_BLOCK_DIM ** -0.5
    gate_a_b = 0.01 * jax.random.normal(ks[6], (LRU_BLOCKS, LRU_BLOCK_DIM), f32)
    gate_x_w = jax.random.normal(ks[7], (LRU_BLOCKS, LRU_BLOCK_DIM, LRU_BLOCK_DIM), f32) * LRU_BLOCK_DIM ** -0.5
    gate_x_b = 0.01 * jax.random.normal(ks[8], (LRU_BLOCKS, LRU_BLOCK_DIM), f32)
    a_c = jax.random.uniform(ks[9], (LRU_WIDTH,), f32, minval=0.9, maxval=0.999)
    a0 = a_c ** (1.0 / LRU_C)
    lru_lambda = jnp.log(a0) - jnp.log1p(-a0)
    w_out = jax.random.normal(ks[10], (MIX_WIDTH, D_MODEL), f32) * MIX_WIDTH ** -0.5
    norm_out_g = 1.0 + 0.05 * jax.random.normal(ks[11], (D_MODEL,), f32)
    return {"x": x, "norm_in_g": norm_in_g, "w_in": w_in, "conv_w": conv_w, "conv_b": conv_b,
            "gate_a_w": gate_a_w, "gate_a_b": gate_a_b, "gate_x_w": gate_x_w, "gate_x_b": gate_x_b,
            "lru_lambda": lru_lambda, "w_out": w_out, "norm_out_g": norm_out_g}


def reference(x, norm_in_g, w_in, conv_w, conv_b, gate_a_w, gate_a_b, gate_x_w, gate_x_b,
              lru_lambda, w_out, norm_out_g):
    B, T, _ = x.shape
    f32 = jnp.float32
    h = x
    for _layer in range(DEPTH):
        xn = rms_norm(h, norm_in_g)
        proj = jnp.einsum('btd,de->bte', xn, w_in).astype(f32)
        q, k, v, g_ret, x_lru, g_lru = jnp.split(proj, IN_SPLITS, axis=-1)

        q = rotary(q.reshape(B, T, RET_HEADS, RET_HEAD_DIM))
        k = rotary(k.reshape(B, T, RET_HEADS, RET_HEAD_DIM)) * RET_HEAD_DIM ** -0.5
        v = v.reshape(B, T, RET_HEADS, RET_HEAD_DIM)
        o_ret = group_norm_heads(chunkwise_retention(q, k, v)).reshape(B, T, RET_WIDTH)
        y_ret = o_ret * jax.nn.silu(g_ret)

        xc = causal_depthwise_conv(x_lru, conv_w.astype(f32), conv_b.astype(f32))
        o_lru = rg_lru(xc, gate_a_w.astype(f32), gate_a_b.astype(f32), gate_x_w.astype(f32),
                       gate_x_b.astype(f32), lru_lambda.astype(f32))
        y_lru = o_lru * jax.nn.silu(g_lru)

        mixed = jnp.concatenate([y_ret, y_lru], axis=-1).astype(x.dtype)
        h = h + jnp.einsum('bte,ed->btd', mixed, w_out)
    return rms_norm(h, norm_out_g)
```

```cpp
#include <hip/hip_runtime.h>
#include <cstdio>
#include <cstdint>

#ifndef MK_N_LAUNCHES
#define MK_N_LAUNCHES 6
#endif

namespace pg8 {
#define PG8_LAS __attribute__((address_space(3)))
typedef unsigned short bf16_t;
typedef short bf16x8 __attribute__((ext_vector_type(8)));
typedef float f32x4 __attribute__((ext_vector_type(4)));
typedef unsigned u32x4 __attribute__((ext_vector_type(4)));
constexpr int BM = 256, BK = 64, HALF = 128, HTB = HALF * BK * 2  , STAGE_BYTES = 8 * HTB, NXCD = 8, WGM = 8;

__host__ __device__ __forceinline__ int lds_byte(int r, int c) { const int st = (r >> 4) * 2 + (c >> 5), rr = r & 15, cc = c & 31, ob = rr * 64 + cc * 2; return st * 1024 + (ob ^ (((ob >> 9) & 1) << 5)); }
__host__ __device__ __forceinline__ void stage_rc(int b, int& R, int& C) { const int st = b / 1024, sb = b % 1024, swz = sb ^ (((sb >> 9) & 1) << 5); R = (st >> 1) * 16 + swz / 64; C = (st & 1) * 32 + (swz % 64) / 2; }
__host__ __device__ __forceinline__ int perm32(int rho) { const int n = rho >> 4, i = rho & 15; return 8 * (i >> 2) + 4 * n + (i & 3); }

struct Unit { int pm, pn; };
struct Gemm { const bf16_t* A; const bf16_t* Bt; int M, N, K; };

struct StaticOrder {
    int nM, nN, nwg, G, c;
    __host__ __device__ void init(int M, int N, int G_, int c_) { nM = M / BM; nN = N / BM; nwg = nM * nN; G = G_; c = c_; }
    __host__ __device__ bool next(int i, Unit& u) const {
        const long L = (long)i * G + c; if (L >= nwg) return false;
        int wgid = (int)L; { const int q = nwg / NXCD, r = nwg % NXCD, xcd = wgid % NXCD, off = wgid / NXCD; wgid = (xcd < r ? xcd * (q + 1) : r * (q + 1) + (xcd - r) * q) + off; }
        const int nig = WGM * nN, gid = wgid / nig, fm = gid * WGM, gsz = (nM - fm) < WGM ? (nM - fm) : WGM;
        u.pm = fm + ((wgid % nig) % gsz); u.pn = (wgid % nig) / gsz; return true;
    }
    __device__ __forceinline__ void a_ready(const Unit&) const {}
    __device__ __forceinline__ void done(const Unit&) const {}
};


__device__ __forceinline__ unsigned cvt_pk_bf16(float lo, float hi) { unsigned r; asm volatile("v_cvt_pk_bf16_f32 %0, %1, %2" : "=v"(r) : "v"(lo), "v"(hi)); return r; }
__device__ __forceinline__ float silu_f(float v) { return v * __builtin_amdgcn_rcpf(1.0f + __builtin_amdgcn_exp2f(-1.4426950408889634f * v)); }

struct EpiProj {
    static constexpr bool PERM = true, AFTER_DRAIN = false;
    bf16_t* o_q; bf16_t* o_k; bf16_t* o_v; bf16_t* o_gr; bf16_t* o_xl; bf16_t* o_gl;
    const float* rrow;
    const float* cs;
    __device__ __forceinline__ void operator()(const f32x4 (&acc)[2][2][4][2], const Unit& u, int wr, int wc, int fr, int fq) const {
        const int kind = u.pn >> 2, ct = u.pn & 3;
        const int row0 = u.pm * BM + wr * 64 + fr;
        if (kind >= 2) {
            bf16_t* base = kind == 2 ? o_v : (kind == 3 ? o_gr : (kind == 4 ? o_xl : o_gl));
            const bool act = (kind == 3) || (kind == 5);
            const int col0 = ct * 256 + wc * 32 + 8 * fq;
#pragma unroll
            for (int ai = 0; ai < 2; ++ai)
#pragma unroll
                for (int m = 0; m < 4; ++m) {
                    const int row = row0 + ai * HALF + m * 16; const float r = rrow[row];
                    bf16_t* rowp = base + (size_t)row * 1024 + col0;
#pragma unroll
                    for (int bj = 0; bj < 2; ++bj) {
                        f32x4 v0 = acc[ai][bj][m][0] * r, v1 = acc[ai][bj][m][1] * r;
                        if (act) {
#pragma unroll
                            for (int e = 0; e < 4; ++e) { v0[e] = silu_f(v0[e]); v1[e] = silu_f(v1[e]); }
                        }
                        u32x4 w; w.x = cvt_pk_bf16(v0[0], v0[1]); w.y = cvt_pk_bf16(v0[2], v0[3]); w.z = cvt_pk_bf16(v1[0], v1[1]); w.w = cvt_pk_bf16(v1[2], v1[3]);
                        *(u32x4*)(rowp + bj * HALF) = w;
                    }
                }
        } else {
            bf16_t* base = kind == 0 ? o_q : o_k;
            const int hl = wc >> 1, h = ct * 2 + hl, j0 = 32 * (wc & 1) + 8 * fq;
            const float lg = __builtin_log2f(1.0f - __builtin_exp2f(-5.0f - (float)h));
            const float sgn = kind == 0 ? lg : -lg, kmul = kind == 0 ? 1.0f : 0.08838834764831845f;
#pragma unroll
            for (int ai = 0; ai < 2; ++ai)
#pragma unroll
                for (int m = 0; m < 4; ++m) {
                    const int row = row0 + ai * HALF + m * 16; const int t = row & 8191;
                    const float f = rrow[row] * kmul * __builtin_amdgcn_exp2f(sgn * (float)(t & 127));
                    const f32x4* cp = (const f32x4*)(cs + ((size_t)t * 64 + j0) * 2);
                    const f32x4 c0 = cp[0], c1 = cp[1], c2 = cp[2], c3 = cp[3];
                    const f32x4 x1a = acc[ai][0][m][0], x1b = acc[ai][0][m][1], x2a = acc[ai][1][m][0], x2b = acc[ai][1][m][1];
                    float o1[8], o2[8];
                    o1[0] = (x1a[0] * c0[0] - x2a[0] * c0[1]) * f; o2[0] = (x1a[0] * c0[1] + x2a[0] * c0[0]) * f;
                    o1[1] = (x1a[1] * c0[2] - x2a[1] * c0[3]) * f; o2[1] = (x1a[1] * c0[3] + x2a[1] * c0[2]) * f;
                    o1[2] = (x1a[2] * c1[0] - x2a[2] * c1[1]) * f; o2[2] = (x1a[2] * c1[1] + x2a[2] * c1[0]) * f;
                    o1[3] = (x1a[3] * c1[2] - x2a[3] * c1[3]) * f; o2[3] = (x1a[3] * c1[3] + x2a[3] * c1[2]) * f;
                    o1[4] = (x1b[0] * c2[0] - x2b[0] * c2[1]) * f; o2[4] = (x1b[0] * c2[1] + x2b[0] * c2[0]) * f;
                    o1[5] = (x1b[1] * c2[2] - x2b[1] * c2[3]) * f; o2[5] = (x1b[1] * c2[3] + x2b[1] * c2[2]) * f;
                    o1[6] = (x1b[2] * c3[0] - x2b[2] * c3[1]) * f; o2[6] = (x1b[2] * c3[1] + x2b[2] * c3[0]) * f;
                    o1[7] = (x1b[3] * c3[2] - x2b[3] * c3[3]) * f; o2[7] = (x1b[3] * c3[3] + x2b[3] * c3[2]) * f;
                    bf16_t* rowp = base + (size_t)row * 1024 + h * 128 + j0;
                    u32x4 w1, w2;
                    w1.x = cvt_pk_bf16(o1[0], o1[1]); w1.y = cvt_pk_bf16(o1[2], o1[3]); w1.z = cvt_pk_bf16(o1[4], o1[5]); w1.w = cvt_pk_bf16(o1[6], o1[7]);
                    w2.x = cvt_pk_bf16(o2[0], o2[1]); w2.y = cvt_pk_bf16(o2[2], o2[3]); w2.z = cvt_pk_bf16(o2[4], o2[5]); w2.w = cvt_pk_bf16(o2[6], o2[7]);
                    *(u32x4*)(rowp) = w1; *(u32x4*)(rowp + 64) = w2;
                    asm volatile("" ::: "memory");
                }
        }
    }
};
struct EpiOut {
    static constexpr bool PERM = false, AFTER_DRAIN = false;
    const float* x; float* out;
    __device__ __forceinline__ void operator()(const f32x4 (&acc)[2][2][4][2], const Unit& u, int wr, int wc, int fr, int fq) const {
        const int col0 = u.pn * BM + wc * 32 + 4 * fq;
#pragma unroll
        for (int ai = 0; ai < 2; ++ai)
#pragma unroll
            for (int m = 0; m < 4; ++m) {
                const size_t off = (size_t)(u.pm * BM + ai * HALF + wr * 64 + m * 16 + fr) * 1024 + col0;
#pragma unroll
                for (int bj = 0; bj < 2; ++bj)
#pragma unroll
                    for (int n = 0; n < 2; ++n) { const f32x4 xv = *(const f32x4*)(x + off + bj * HALF + n * 16); *(f32x4*)(out + off + bj * HALF + n * 16) = xv + acc[ai][bj][m][n]; }
                if (m & 1) asm volatile("" ::: "memory");
            }
    }
};

template <class Epi, class Sched, bool ALIGN_EPI = false, bool SP2 = false>
__device__ __forceinline__ void gemm_phase(PG8_LAS unsigned char* lds, const Gemm g, const Sched& S, const Epi& E) {
    const int tid = threadIdx.x, wid = __builtin_amdgcn_readfirstlane(tid >> 6), lane = tid & 63, wr = wid >> 2, wc = wid & 3, fr = lane & 15, fq = lane >> 4;
    const int K = g.K, nt = K / BK;
    unsigned voffA[2], voffB[2];
#pragma unroll
    for (int i = 0; i < 2; ++i) { int R, C; stage_rc(tid * 16 + i * 8192, R, C); const int Rb = Epi::PERM ? ((R & ~31) + perm32(R & 31)) : R;
        voffA[i] = (unsigned)(R * K + C) * 2u; voffB[i] = (unsigned)(Rb * K + C) * 2u; }
    const size_t kstep = (size_t)(BK * 2);
    const size_t hstep = (size_t)HALF * K * 2;
    const size_t tstep = 2 * hstep;
    const unsigned ldsw = (unsigned)wid * 1024u;
    const int aoff = lds_byte(wr * 64 + fr, fq * 8), boff = lds_byte(wc * 32 + fr, fq * 8);
#define PG8_SA(b, h) (((b) * 2 + (h)) * HTB)
#define PG8_SB(b, h) ((4 + (b) * 2 + (h)) * HTB)
#define PG8_STAGE(bufoff, gbase, voff) do { _Pragma("unroll") for (int _i = 0; _i < 2; ++_i) \
        __builtin_amdgcn_global_load_lds((const unsigned*)((const char*)(gbase) + (voff)[_i]), (PG8_LAS unsigned*)(lds + (bufoff) + ldsw + _i * 8192), 16, 0, 0); } while (0)
#define PG8_LDA(dst, b, h) do { _Pragma("unroll") for (int m = 0; m < 4; ++m) _Pragma("unroll") for (int k = 0; k < 2; ++k) dst[m][k] = *(const PG8_LAS bf16x8*)(lds + PG8_SA(b, h) + aoff + m * 2048 + k * 1024); } while (0)
#define PG8_LDB(dst, b, h) do { _Pragma("unroll") for (int n = 0; n < 2; ++n) _Pragma("unroll") for (int k = 0; k < 2; ++k) dst[n][k] = *(const PG8_LAS bf16x8*)(lds + PG8_SB(b, h) + boff + n * 2048 + k * 1024); } while (0)
#define PG8_MMA(ai, bj, At, Bt) do { __builtin_amdgcn_s_setprio(1); _Pragma("unroll") for (int m = 0; m < 4; ++m) _Pragma("unroll") for (int n = 0; n < 2; ++n) _Pragma("unroll") for (int k = 0; k < 2; ++k) \
        acc[ai][bj][m][n] = __builtin_amdgcn_mfma_f32_16x16x32_bf16(Bt[n][k], At[m][k], acc[ai][bj][m][n], 0, 0, 0); __builtin_amdgcn_s_setprio(0); } while (0)
#define PG8_WAIT_V(n) asm volatile("s_waitcnt vmcnt(" #n ")" ::: "memory")
#define PG8_WAIT_L(n) asm volatile("s_waitcnt lgkmcnt(" #n ")" ::: "memory")
#define PG8_BAR __builtin_amdgcn_s_barrier()
#define PG8_SCHED __builtin_amdgcn_sched_barrier(0)
    Unit cur, nxt; int ui = 0;
    if (!S.next(0, cur)) return;
    f32x4 acc[2][2][4][2];
#pragma unroll
    for (int a = 0; a < 2; ++a)
#pragma unroll
        for (int b = 0; b < 2; ++b)
#pragma unroll
            for (int m = 0; m < 4; ++m)
#pragma unroll
                for (int n = 0; n < 2; ++n) acc[a][b][m][n] = (f32x4){0.f, 0.f, 0.f, 0.f};
    bf16x8 At[4][2], B0[2][2], B1[2][2];
    const char* cA = (const char*)g.A + (size_t)cur.pm * tstep; const char* cB = (const char*)g.Bt + (size_t)cur.pn * tstep;
    S.a_ready(cur);
    if constexpr (SP2) {
        PG8_STAGE(PG8_SB(0, 0), cB, voffB); PG8_STAGE(PG8_SB(0, 1), cB + hstep, voffB); PG8_STAGE(PG8_SA(0, 0), cA, voffA); PG8_STAGE(PG8_SA(0, 1), cA + hstep, voffA);
        if (wr == 1) PG8_BAR;
        PG8_WAIT_V(2); PG8_BAR;
        PG8_STAGE(PG8_SB(1, 0), cB + kstep, voffB); PG8_STAGE(PG8_SA(1, 0), cA + kstep, voffA); PG8_STAGE(PG8_SB(1, 1), cB + hstep + kstep, voffB);
        PG8_WAIT_V(6); PG8_BAR;
    } else {
        PG8_STAGE(PG8_SB(0, 0), cB, voffB); PG8_STAGE(PG8_SA(0, 0), cA, voffA); PG8_STAGE(PG8_SB(0, 1), cB + hstep, voffB); PG8_STAGE(PG8_SA(0, 1), cA + hstep, voffA);
        if (wr == 1) PG8_BAR;
        PG8_WAIT_V(4); PG8_BAR;
        PG8_STAGE(PG8_SB(1, 0), cB + kstep, voffB); PG8_STAGE(PG8_SA(1, 0), cA + kstep, voffA); PG8_STAGE(PG8_SB(1, 1), cB + hstep + kstep, voffB);
        PG8_WAIT_V(6); PG8_BAR;
    }
    for (;;) {
        const bool has_next = S.next(ui + 1, nxt);
        const char* nA = has_next ? (const char*)g.A + (size_t)nxt.pm * tstep : cA; const char* nB = has_next ? (const char*)g.Bt + (size_t)nxt.pn * tstep : cB;
        for (int t = 0; t < nt; t += 2) {
            const bool last = (t == nt - 2);
            const char* a1 = cA + (size_t)(t + 1) * kstep;
            const char* a2 = last ? nA : cA + (size_t)(t + 2) * kstep; const char* b2 = last ? nB : cB + (size_t)(t + 2) * kstep;
            const char* a3 = a2 + kstep; const char* b3 = b2 + kstep;
            if (last && has_next) S.a_ready(nxt);
            if constexpr (SP2) {
            PG8_LDB(B0, 0, 0); PG8_LDB(B1, 0, 1); PG8_SCHED; PG8_LDA(At, 0, 0); PG8_STAGE(PG8_SA(1, 1), a1 + hstep, voffA);
            PG8_WAIT_V(8); PG8_WAIT_L(0); PG8_BAR; PG8_MMA(0, 0, At, B0); PG8_MMA(0, 1, At, B1); PG8_BAR; PG8_SCHED;
            PG8_LDA(At, 0, 1); PG8_STAGE(PG8_SB(0, 0), b2, voffB); PG8_STAGE(PG8_SB(0, 1), b2 + hstep, voffB); PG8_STAGE(PG8_SA(0, 0), a2, voffA);
            PG8_WAIT_V(8); PG8_WAIT_L(0); PG8_BAR; PG8_MMA(1, 0, At, B0); PG8_MMA(1, 1, At, B1); PG8_BAR; PG8_SCHED;
            PG8_LDB(B0, 1, 0); PG8_LDB(B1, 1, 1); PG8_SCHED; PG8_LDA(At, 1, 0); PG8_STAGE(PG8_SA(0, 1), a2 + hstep, voffA);
            PG8_WAIT_V(8); PG8_WAIT_L(0); PG8_BAR; PG8_MMA(0, 0, At, B0); PG8_MMA(0, 1, At, B1); PG8_BAR; PG8_SCHED;
            PG8_LDA(At, 1, 1); PG8_STAGE(PG8_SB(1, 0), b3, voffB); PG8_STAGE(PG8_SB(1, 1), b3 + hstep, voffB); PG8_STAGE(PG8_SA(1, 0), a3, voffA);
            PG8_WAIT_V(8); PG8_WAIT_L(0); PG8_BAR; PG8_MMA(1, 0, At, B0); PG8_MMA(1, 1, At, B1); PG8_BAR; PG8_SCHED;
            } else {
            PG8_LDB(B0, 0, 0); PG8_SCHED; PG8_LDA(At, 0, 0); PG8_STAGE(PG8_SA(1, 1), a1 + hstep, voffA);
            PG8_WAIT_L(8); PG8_BAR; PG8_WAIT_L(0); PG8_MMA(0, 0, At, B0); PG8_BAR; PG8_SCHED;
            PG8_LDB(B1, 0, 1); PG8_STAGE(PG8_SB(0, 0), b2, voffB);
            PG8_BAR; PG8_WAIT_L(0); PG8_MMA(0, 1, At, B1); PG8_BAR;
            PG8_LDA(At, 0, 1); PG8_STAGE(PG8_SA(0, 0), a2, voffA);
            PG8_BAR; PG8_WAIT_L(0); PG8_MMA(1, 0, At, B0); PG8_BAR; PG8_SCHED;
            PG8_STAGE(PG8_SB(0, 1), b2 + hstep, voffB);
            PG8_WAIT_V(6); PG8_BAR; PG8_MMA(1, 1, At, B1); PG8_BAR;
            PG8_LDB(B0, 1, 0); PG8_SCHED; PG8_LDA(At, 1, 0); PG8_STAGE(PG8_SA(0, 1), a2 + hstep, voffA);
            PG8_WAIT_L(8); PG8_BAR; PG8_WAIT_L(0); PG8_MMA(0, 0, At, B0); PG8_BAR; PG8_SCHED;
            PG8_LDB(B1, 1, 1); PG8_STAGE(PG8_SB(1, 0), b3, voffB);
            PG8_BAR; PG8_WAIT_L(0); PG8_MMA(0, 1, At, B1); PG8_BAR;
            PG8_LDA(At, 1, 1); PG8_STAGE(PG8_SA(1, 0), a3, voffA);
            PG8_BAR; PG8_WAIT_L(0); PG8_MMA(1, 0, At, B0); PG8_BAR; PG8_SCHED;
            PG8_STAGE(PG8_SB(1, 1), b3 + hstep, voffB);
            PG8_WAIT_V(6); PG8_BAR; PG8_MMA(1, 1, At, B1); PG8_BAR;
            }
        }
        if constexpr (ALIGN_EPI) { if (wr == 0) PG8_BAR; }
        if constexpr (!Epi::AFTER_DRAIN) { E(acc, cur, wr, wc, fr, fq); S.done(cur); }
        if (!has_next) break;
#pragma unroll
        for (int a = 0; a < 2; ++a)
#pragma unroll
            for (int b = 0; b < 2; ++b)
#pragma unroll
                for (int m = 0; m < 4; ++m)
#pragma unroll
                    for (int n = 0; n < 2; ++n) acc[a][b][m][n] = (f32x4){0.f, 0.f, 0.f, 0.f};
        cur = nxt; cA = nA; cB = nB; ++ui;
        if constexpr (ALIGN_EPI) { if (wr == 1) PG8_BAR; }
    }
    PG8_WAIT_V(0);
    if constexpr (!ALIGN_EPI) { if (wr == 0) PG8_BAR; }
    PG8_BAR;
    if constexpr (Epi::AFTER_DRAIN) { E.fused(acc, cur, wr, wc, fr, fq, lds, wid, lane); S.done(cur); }
#undef PG8_SA
#undef PG8_SB
#undef PG8_STAGE
#undef PG8_LDA
#undef PG8_LDB
#undef PG8_MMA
#undef PG8_WAIT_V
#undef PG8_WAIT_L
#undef PG8_BAR
#undef PG8_SCHED
}
}

#ifndef PG8_SP2
#define PG8_SP2 true
#endif
#ifndef PG8_ALIGN
#define PG8_ALIGN true
#endif

constexpr int NWAVES = 8;
constexpr int N_LAUNCHES = MK_N_LAUNCHES;
constexpr int PER_PHASE = 6;
constexpr int BATCH = 4, T = 8192, DM = 1024, M = BATCH * T, NIN = 6144, NH = 8, HD = 128, CHUNK = 128, MIXW = 2048;
constexpr int RSEG_CH = 8, NRSEG = 8;
constexpr int LSEG_TOK = 1024, NLSEG = 8, LTILE = 128;
constexpr float NORM_EPS = 1e-6f;

constexpr size_t MiB = 1u << 20;
constexpr size_t WS_CTL = 0, CTL_ZERO_BYTES = 1 * MiB;
constexpr size_t WS_WIN = 1 * MiB;
constexpr size_t WS_WOUT = 13 * MiB;
constexpr size_t WS_WG = 17 * MiB;
constexpr size_t WS_CS = 18 * MiB;
constexpr size_t WS_RROW = 22 * MiB;
constexpr size_t WS_LSUM = 22 * MiB + 512 * 1024;
constexpr size_t WS_RSUM = 24 * MiB;
constexpr size_t WS_Q = 48 * MiB, WS_K = 112 * MiB, WS_V = 176 * MiB, WS_GR = 240 * MiB, WS_GL = 304 * MiB;
constexpr size_t WS_MIX = 368 * MiB;
constexpr size_t WS_END = 496 * MiB;
constexpr size_t OUT_XB = 0, OUT_XL = 64 * MiB;
constexpr int CW_BAR = 4096;

constexpr int RING_OFF = 0, RING_BYTES = 131072;
constexpr int LDSCTL_OFF = RING_BYTES, MISC_OFF = LDSCTL_OFF + 320;
constexpr int LDS_BYTES = 147456;

#define GAS __attribute__((address_space(1)))
#define LAS __attribute__((address_space(3)))
typedef unsigned short bf16;
typedef unsigned v4u __attribute__((ext_vector_type(4)));
typedef unsigned v2u __attribute__((ext_vector_type(2)));
typedef float f32x4 __attribute__((ext_vector_type(4)));
typedef float f32x2 __attribute__((ext_vector_type(2)));
typedef short bf16x8 __attribute__((ext_vector_type(8)));
typedef short s16x4 __attribute__((ext_vector_type(4)));
typedef GAS unsigned gu32;
#define RLX_AGENT __ATOMIC_RELAXED, __HIP_MEMORY_SCOPE_AGENT
#define LDS_WAIT() asm volatile("s_waitcnt lgkmcnt(0)" ::: "memory")
#define VM_WAIT() asm volatile("s_waitcnt vmcnt(0)" ::: "memory")
__device__ __forceinline__ unsigned pk2(float lo, float hi) { return pg8::cvt_pk_bf16(lo, hi); }
__device__ __forceinline__ float bf_lo(unsigned u) { return __uint_as_float(u << 16); }
__device__ __forceinline__ float bf_hi(unsigned u) { return __uint_as_float(u & 0xffff0000u); }
__device__ __forceinline__ unsigned short f2bf1(float f) { return (unsigned short)(pg8::cvt_pk_bf16(f, 0.f) & 0xffffu); }

#define XB_TMO      128
#define XB_XCNT(j)  (256  + 64 * (j))
#define XB_XSUB(j)  (1280 + 64 * (j))
#define XB_XGEN(j)  (2304 + 64 * (j))
#define XB_TOP      3328
#define XB_TOPGEN   3392
#define XCD_BAR_WORDS 3456
#define XB_SPIN_CAP (1u << 18)

__device__ __forceinline__ unsigned xb_ld(unsigned* p)              { return __hip_atomic_load(p, __ATOMIC_RELAXED, __HIP_MEMORY_SCOPE_AGENT); }
__device__ __forceinline__ unsigned xb_add(unsigned* p, unsigned v) { return __hip_atomic_fetch_add(p, v, __ATOMIC_RELAXED, __HIP_MEMORY_SCOPE_AGENT); }
__device__ __forceinline__ unsigned xb_xcc_id() { return (unsigned)__builtin_amdgcn_s_getreg((3 << 11) | 20) & 0xFu; }
#define XB_SPIN(cond, bar) do { unsigned _sp = 0; while (cond) { __builtin_amdgcn_s_sleep(1); \
    if ((++_sp & 255u) == 0u) { if (xb_ld(&(bar)[XB_TMO])) break; if (_sp > XB_SPIN_CAP) { atomicAdd(&(bar)[XB_TMO], 1u); break; } } } } while (0)

struct XcdBarrier {
    unsigned* bar; unsigned x;
    volatile LAS unsigned* st;
};

__device__ __forceinline__ XcdBarrier xcd_barrier_post(unsigned* bar, volatile LAS unsigned* st) {
    XcdBarrier b; b.bar = bar; b.x = xb_xcc_id(); b.st = st;
    if (threadIdx.x == 0) (void)xb_add(&bar[XB_XCNT(b.x)], 1u);
    return b;
}
__device__ __forceinline__ void xcd_barrier_complete(unsigned* bar, unsigned x, unsigned& nloc, unsigned& nx) {
    const unsigned G = gridDim.x * gridDim.y * gridDim.z;
    unsigned sum, cnt, mine, sp = 0u;
    for (;;) {
        sum = 0u; cnt = 0u; mine = 0u;
#pragma unroll
        for (unsigned j = 0; j < 16; ++j) { const unsigned c = xb_ld(&bar[XB_XCNT(j)]); sum += c; cnt += (c > 0u) ? 1u : 0u; mine = (j == x) ? c : mine; }
        if (sum == G) break;
        __builtin_amdgcn_s_sleep(1);
        if ((++sp & 255u) == 0u) { if (xb_ld(&bar[XB_TMO])) break; if (sp > XB_SPIN_CAP) { atomicAdd(&bar[XB_TMO], 1u); break; } }
    }
    nloc = mine > 0u ? mine : 1u; nx = cnt > 0u ? cnt : 1u;
}

__device__ __forceinline__ void xcd_barrier(const XcdBarrier& b) {
    asm volatile("s_waitcnt vmcnt(0)" ::: "memory");
    __syncthreads();
    if (threadIdx.x == 0) {
        unsigned* bar = b.bar;
        __builtin_amdgcn_s_waitcnt(0);
        unsigned nloc = b.st[0], nx = b.st[1];
        if (nloc == 0u) { xcd_barrier_complete(bar, b.x, nloc, nx); b.st[0] = nloc; b.st[1] = nx; }
        const unsigned old = xb_add(&bar[XB_XSUB(b.x)], 1u);
        const unsigned gen = old / nloc;
        if (old + 1u == (gen + 1u) * nloc) {
            __builtin_amdgcn_fence(__ATOMIC_RELEASE, "agent");
            asm volatile("s_waitcnt vmcnt(0)" ::: "memory");
            const unsigned og = xb_add(&bar[XB_TOP], 1u);
            const unsigned tg = og / nx;
            if (og + 1u == (tg + 1u) * nx) xb_add(&bar[XB_TOPGEN], 1u);
            else XB_SPIN(xb_ld(&bar[XB_TOPGEN]) == tg, bar);
            __builtin_amdgcn_fence(__ATOMIC_ACQUIRE, "agent");
            xb_add(&bar[XB_XGEN(b.x)], 1u);
            asm volatile("s_waitcnt vmcnt(0)" ::: "memory");
        } else {
            XB_SPIN(xb_ld(&bar[XB_XGEN(b.x)]) == gen, bar);
            __builtin_amdgcn_fence(__ATOMIC_ACQUIRE, "agent");
            asm volatile("s_waitcnt vmcnt(0)" ::: "memory");
        }
    }
    __syncthreads();
}

struct Frame {
    LAS unsigned char* lds;
    volatile LAS unsigned* MISC;
    gu32* ctl;
    int tid, lane, wave;
    int vcu, G;
    const float *x, *norm_in_g, *w_in, *conv_w, *conv_b, *ga_w, *ga_b, *gx_w, *gx_b, *lam, *w_out, *norm_out_g;
    float* out;
    bf16 *WIN, *WOUT, *WAT, *WXT, *XB, *Q, *K, *V, *GR, *XL, *GL, *MIX;
    float *CS, *RROW, *LSUM, *RSUM;
};

__device__ __forceinline__ float wave_sum(float v) {
#pragma unroll
    for (int o = 1; o < 64; o <<= 1) v += __shfl_xor(v, o);
    return v;
}

constexpr int TS = 288, TILE_BYTES = 128 * TS;
__device__ __forceinline__ unsigned toff(unsigned row, unsigned ch) { return (unsigned)TS * row + 16u * ch; }
__device__ __forceinline__ LAS unsigned char* rowbase(LAS unsigned char* tile, int lane) { return tile + TS * (lane & 15) + 16 * (lane >> 4); }
__device__ __forceinline__ LAS unsigned char* trbase(LAS unsigned char* tile, int lane) { return tile + TS * (4 * (lane >> 4) + ((lane & 15) >> 2)) + 16 * ((lane & 3) >> 1) + 8 * (lane & 1); }
#define ROW_FRAG(rb_, rbk, s) (*(const LAS bf16x8*)((rb_) + (rbk) * 16 * TS + (s) * 64))
#define TR_BLK(tb_, R0, c) __builtin_amdgcn_ds_read_tr16_b64_v4i16((LAS s16x4*)((tb_) + (R0) * TS + (c) * 32))
#define TR_FRAG(dst, tb_, K0, c) do { const s16x4 lo_ = TR_BLK(tb_, K0, c), hi_ = TR_BLK(tb_, (K0) + 16, c); dst = (bf16x8){lo_[0], lo_[1], lo_[2], lo_[3], hi_[0], hi_[1], hi_[2], hi_[3]}; } while (0)
#define MFMA16(a, b, c) __builtin_amdgcn_mfma_f32_16x16x32_bf16((a), (b), (c), 0, 0, 0)

__device__ __forceinline__ void p0_transpose_item(const float* W, int K, int N, bf16* WT, int k0, int n0l, int n0p, const float* kscale, LAS float* scr, int lane) {
#pragma unroll 8
    for (int i = 0; i < 32; ++i) { const int kk = 2 * i + (lane >> 5); float v = W[(size_t)(k0 + kk) * N + n0l + (lane & 31)]; if (kscale) v *= kscale[k0 + kk]; scr[kk * 33 + (lane & 31)] = v; }
    LDS_WAIT(); asm volatile("" ::: "memory");
    const int c = lane & 7;
#pragma unroll
    for (int j = 0; j < 4; ++j) { const int n = (lane >> 3) + 8 * j; const LAS float* s = scr + (8 * c) * 33 + n;
        v4u o; o.x = pk2(s[0 * 33], s[1 * 33]); o.y = pk2(s[2 * 33], s[3 * 33]); o.z = pk2(s[4 * 33], s[5 * 33]); o.w = pk2(s[6 * 33], s[7 * 33]);
        *(GAS v4u*)(WT + (size_t)(n0p + n) * K + k0 + 8 * c) = o; }
    LDS_WAIT(); asm volatile("" ::: "memory");
}
__device__ __forceinline__ void p0_prologue(Frame& F) {
    LAS float* scr = (LAS float*)(F.lds + RING_OFF + F.wave * 16384);
    const int gw = F.vcu * NWAVES + F.wave, NGW = F.G * NWAVES;
    constexpr int I_IN = (DM / 64) * (NIN / 32), I_OUT = (MIXW / 64) * (DM / 32), I_G = 16 * 8;
    constexpr int NITEMS = I_IN + I_OUT + I_G;
    for (int it = gw; it < NITEMS; it += NGW) {
        int r = it;
        if (r < I_IN) { const int nblk = NIN / 32, kb = r / nblk, nb = r % nblk; const int p0 = 32 * nb; int nl = p0;
            if (p0 < 2048) { const int tile = p0 >> 8, pp = p0 & 255, half = pp >> 7, within = pp & 127, hl = within >> 6, j = within & 63; nl = tile * 256 + hl * 128 + half * 64 + j; }
            p0_transpose_item(F.w_in, DM, NIN, F.WIN, 64 * kb, nl, p0, F.norm_in_g, scr, F.lane); continue; }
        r -= I_IN;
        if (r < I_OUT) { const int nblk = DM / 32, kb = r / nblk, nb = r % nblk; p0_transpose_item(F.w_out, MIXW, DM, F.WOUT, 64 * kb, 32 * nb, 32 * nb, nullptr, scr, F.lane); continue; }
        r -= I_OUT;
        { const int mat = r >> 3, it8 = r & 7, kb = it8 >> 2, nb = it8 & 3;
          const float* W = (mat < 8 ? F.ga_w : F.gx_w) + (size_t)(mat & 7) * 16384; bf16* WT = (mat < 8 ? F.WAT : F.WXT) + (size_t)(mat & 7) * 16384;
          p0_transpose_item(W, 128, 128, WT, 64 * kb, 32 * nb, 32 * nb, nullptr, scr, F.lane); }
    }
    for (int m = gw; m < M; m += NGW) {
        const GAS f32x4* xr = (const GAS f32x4*)(F.x + (size_t)m * DM) + F.lane;
        f32x4 v[4]; float s = 0.f;
#pragma unroll
        for (int j = 0; j < 4; ++j) { v[j] = xr[64 * j]; s += (v[j].x * v[j].x + v[j].y * v[j].y) + (v[j].z * v[j].z + v[j].w * v[j].w); }
        s = wave_sum(s);
        if (F.lane == 0) F.RROW[m] = 1.0f / sqrtf(s * (1.0f / DM) + NORM_EPS);
        GAS v2u* o8 = (GAS v2u*)(F.XB + (size_t)m * DM) + F.lane;
#pragma unroll
        for (int j = 0; j < 4; ++j) { v2u o; o.x = pk2(v[j].x, v[j].y); o.y = pk2(v[j].z, v[j].w); o8[64 * j] = o; }
    }
    const int gt = (F.vcu * NWAVES + F.wave) * 64 + F.lane, NGT = F.G * NWAVES * 64;
    for (int idx = gt; idx < T * 64; idx += NGT) {
        const int t = idx >> 6, j = idx & 63;
        const float invf = (float)exp2(-(double)j * (13.287712379549449 / 64.0));
        const float ang = (float)t * invf;
        const double rev = (double)ang * 0.15915494309189535; const float fr = (float)(rev - rint(rev));
        f32x2 o; o.x = __builtin_amdgcn_cosf(fr); o.y = __builtin_amdgcn_sinf(fr);
        *(GAS f32x2*)(F.CS + (size_t)idx * 2) = o;
    }
}

template <bool PASS2>
__device__ __forceinline__ void ret_unit(Frame& F, int b, int h, int seg) {
    const int tid = F.tid, lane = F.lane, w = F.wave, g = lane >> 4, c16 = lane & 15;
    LAS unsigned char* KT = F.lds + RING_OFF; LAS unsigned char* VT = KT + TILE_BYTES; LAS unsigned char* ST = KT + 2 * TILE_BYTES;
    LAS unsigned char* const KTr = rowbase(KT, lane); LAS unsigned char* const STr = rowbase(ST, lane); LAS unsigned char* const KTt = trbase(KT, lane); LAS unsigned char* const VTt = trbase(VT, lane);
    const float lg = __builtin_log2f(1.0f - __builtin_exp2f(-5.0f - (float)h));
    const float gam = __builtin_exp2f(lg), gC = __builtin_exp2f(128.0f * lg), gCm1 = __builtin_exp2f(127.0f * lg);
    const size_t row_seg = (size_t)b * T + (size_t)seg * (RSEG_CH * CHUNK);
    const bf16* Kg = F.K + row_seg * 1024 + h * 128; const bf16* Vg = F.V + row_seg * 1024 + h * 128;
    const bf16* Qg = F.Q + row_seg * 1024 + h * 128; const bf16* Gg = F.GR + row_seg * 1024 + h * 128;
    bf16* Og = F.MIX + row_seg * MIXW + h * 128;
    f32x4 st[8];
#pragma unroll
    for (int i = 0; i < 8; ++i) st[i] = (f32x4){0.f, 0.f, 0.f, 0.f};
    if (PASS2) {
        const float gS = __builtin_exp2f(128.0f * RSEG_CH * lg);
        const int ubase = (b * NH + h) * NRSEG;
        for (int s2 = 0; s2 < seg; ++s2) {
            const float* sp = F.RSUM + (size_t)(ubase + s2) * 16384 + (size_t)(16 * w + 4 * g) * 128 + c16;
#pragma unroll
            for (int db = 0; db < 8; ++db)
#pragma unroll
                for (int r = 0; r < 4; ++r) st[db][r] = gS * st[db][r] + sp[r * 128 + 16 * db];
        }
    }
    v4u pk[4], pv[4];
#pragma unroll
    for (int i = 0; i < 4; ++i) { const int id = tid + 512 * i, row = id >> 4, ch = id & 15; pk[i] = *(const GAS v4u*)(Kg + (size_t)row * 1024 + ch * 8); pv[i] = *(const GAS v4u*)(Vg + (size_t)row * 1024 + ch * 8); }
    bf16x8 qn[4];
    if (PASS2) {
#pragma unroll
        for (int s = 0; s < 4; ++s) qn[s] = *(const GAS bf16x8*)(Qg + (size_t)(16 * w + c16) * 1024 + 32 * s + 8 * g);
    }
    __syncthreads();
    for (int n = 0; n < RSEG_CH; ++n) {
#pragma unroll
        for (int i = 0; i < 4; ++i) { const int id = tid + 512 * i, row = id >> 4, ch = id & 15; *(LAS v4u*)(KT + toff(row, ch)) = pk[i]; *(LAS v4u*)(VT + toff(row, ch)) = pv[i]; }
        if (PASS2) {
#pragma unroll
            for (int db = 0; db < 8; ++db)
#pragma unroll
                for (int r = 0; r < 4; ++r) { const int e = 16 * w + 4 * g + r, d = 16 * db + c16; *(LAS unsigned short*)(ST + TS * e + 2 * d) = f2bf1(gam * st[db][r]); }
        }
        __syncthreads();
        bf16x8 qf[4];
        if (PASS2) {
#pragma unroll
            for (int s = 0; s < 4; ++s) qf[s] = qn[s];
        }
        if (n + 1 < RSEG_CH) {
            const size_t ro = (size_t)(n + 1) * CHUNK * 1024;
#pragma unroll
            for (int i = 0; i < 4; ++i) { const int id = tid + 512 * i, row = id >> 4, ch = id & 15; pk[i] = *(const GAS v4u*)(Kg + ro + (size_t)row * 1024 + ch * 8); pv[i] = *(const GAS v4u*)(Vg + ro + (size_t)row * 1024 + ch * 8); }
            if (PASS2) {
#pragma unroll
                for (int s = 0; s < 4; ++s) qn[s] = *(const GAS bf16x8*)(Qg + ro + (size_t)(16 * w + c16) * 1024 + 32 * s + 8 * g);
            }
        }
        if (PASS2) {
            const size_t trow = (size_t)n * CHUNK + 16 * w + c16;
            bf16x8 pb[4];
#pragma unroll
            for (int s2 = 0; s2 < 4; ++s2) {
                f32x4 sa[2];
#pragma unroll
                for (int hh = 0; hh < 2; ++hh) {
                    const int kb = 2 * s2 + hh;
                    sa[hh] = (f32x4){0.f, 0.f, 0.f, 0.f};
                    if (kb <= w) {
#pragma unroll
                        for (int s = 0; s < 4; ++s) sa[hh] = MFMA16(ROW_FRAG(KTr, kb, s), qf[s], sa[hh]);
                        if (kb == w) {
#pragma unroll
                            for (int r = 0; r < 4; ++r) if (4 * g + r > c16) sa[hh][r] = 0.f;
                        }
                    }
                }
                v4u u; u.x = pk2(sa[0][0], sa[0][1]); u.y = pk2(sa[0][2], sa[0][3]); u.z = pk2(sa[1][0], sa[1][1]); u.w = pk2(sa[1][2], sa[1][3]);
                pb[s2] = __builtin_bit_cast(bf16x8, u);
            }
            f32x4 oacc[8];
#pragma unroll
            for (int eb = 0; eb < 8; ++eb) oacc[eb] = (f32x4){0.f, 0.f, 0.f, 0.f};
#pragma unroll
            for (int s = 0; s < 4; ++s) {
                if (2 * s <= w) {
#pragma unroll
                    for (int eb = 0; eb < 8; ++eb) {
                        bf16x8 a; TR_FRAG(a, VTt, 32 * s, eb);
                        oacc[eb] = MFMA16(a, pb[s], oacc[eb]);
                    }
                }
            }
#pragma unroll
            for (int s = 0; s < 4; ++s)
#pragma unroll
                for (int eb = 0; eb < 8; ++eb) oacc[eb] = MFMA16(ROW_FRAG(STr, eb, s), qf[s], oacc[eb]);
            v2u gv[8];
#pragma unroll
            for (int eb = 0; eb < 8; ++eb) gv[eb] = *(const GAS v2u*)(Gg + trow * 1024 + 16 * eb + 4 * g);
            float sm = 0.f;
#pragma unroll
            for (int eb = 0; eb < 8; ++eb) sm += (oacc[eb][0] + oacc[eb][1]) + (oacc[eb][2] + oacc[eb][3]);
            sm += __shfl_xor(sm, 16); sm += __shfl_xor(sm, 32);
            const float mean = sm * (1.0f / 128.0f);
            float vs = 0.f;
#pragma unroll
            for (int eb = 0; eb < 8; ++eb) { const f32x4 d = oacc[eb] - mean; vs += (d[0] * d[0] + d[1] * d[1]) + (d[2] * d[2] + d[3] * d[3]); }
            vs += __shfl_xor(vs, 16); vs += __shfl_xor(vs, 32);
            const float rstd = 1.0f / sqrtf(vs * (1.0f / 128.0f) + NORM_EPS);
#pragma unroll
            for (int eb = 0; eb < 8; ++eb) {
                const f32x4 y = (oacc[eb] - mean) * rstd;
                v2u o; o.x = pk2(y[0] * bf_lo(gv[eb].x), y[1] * bf_hi(gv[eb].x)); o.y = pk2(y[2] * bf_lo(gv[eb].y), y[3] * bf_hi(gv[eb].y));
                *(GAS v2u*)(Og + trow * MIXW + 16 * eb + 4 * g) = o;
            }
        }
        {
            f32x4 kacc[8];
#pragma unroll
            for (int db = 0; db < 8; ++db) kacc[db] = (f32x4){0.f, 0.f, 0.f, 0.f};
#pragma unroll
            for (int s = 0; s < 4; ++s) {
                bf16x8 a; TR_FRAG(a, VTt + 32 * w, 32 * s, 0);
#pragma unroll
                for (int db = 0; db < 8; ++db) {
                    bf16x8 bb; TR_FRAG(bb, KTt, 32 * s, db);
                    kacc[db] = MFMA16(a, bb, kacc[db]);
                }
            }
#pragma unroll
            for (int db = 0; db < 8; ++db) st[db] = gC * st[db] + gCm1 * kacc[db];
        }
        __syncthreads();
    }
    if (!PASS2) {
        float* sp = F.RSUM + (size_t)((b * NH + h) * NRSEG + seg) * 16384 + (size_t)(16 * w + 4 * g) * 128 + c16;
#pragma unroll
        for (int db = 0; db < 8; ++db)
#pragma unroll
            for (int r = 0; r < 4; ++r) sp[r * 128 + 16 * db] = st[db][r];
    }
}

__device__ __forceinline__ float sigmoid_f(float v) { return __builtin_amdgcn_rcpf(1.0f + __builtin_amdgcn_exp2f(-1.4426950408889634f * v)); }
template <bool PASS2>
__device__ __forceinline__ void lru_unit(Frame& F, int b, int blk, int seg) {
    const int tid = F.tid, lane = F.lane, w = F.wave, g = lane >> 4, c16 = lane & 15;
    LAS unsigned char* XC = F.lds + RING_OFF; LAS unsigned char* HT = XC + TILE_BYTES; LAS unsigned char* const XCr = rowbase(XC, lane);
    const int och = blk * 128 + 16 * w + c16;
    bf16x8 wa[4], wx[4];
#pragma unroll
    for (int s = 0; s < 4; ++s) { wa[s] = *(const GAS bf16x8*)(F.WAT + (size_t)och * 128 + 32 * s + 8 * g); wx[s] = *(const GAS bf16x8*)(F.WXT + (size_t)och * 128 + 32 * s + 8 * g); }
    const float ba = F.ga_b[och], bx = F.gx_b[och];
    const float lamv = F.lam[och];
    const float spv = (lamv > 15.f) ? __expf(-lamv) : log1pf(__expf(-lamv));
    const float m8 = -8.0f * spv * 1.4426950408889634f;
    bf16x8 idf;
    { const int cl = 16 * (w & 1) + c16 - 8 * g;
#pragma unroll
      for (int j = 0; j < 8; ++j) idf[j] = (j == cl) ? (short)0x3f80 : (short)0; }
    const int cg = tid & 15, tq = tid >> 4;
    float cw[4][8], cb[8];
#pragma unroll
    for (int i = 0; i < 8; ++i) { cb[i] = F.conv_b[blk * 128 + 8 * cg + i];
#pragma unroll
        for (int j = 0; j < 4; ++j) cw[j][i] = F.conv_w[j * 1024 + blk * 128 + 8 * cg + i]; }
    float hc = 0.f, ptot = 1.f;
    if (PASS2) {
        for (int s2 = 0; s2 < seg; ++s2) { const f32x2 ph = *(const GAS f32x2*)(F.LSUM + ((size_t)(b * NLSEG + s2) * 1024 + och) * 2); hc = ph.x * hc + ph.y; }
    }
    const size_t rowb = (size_t)b * T;
    for (int tile = 0; tile < LSEG_TOK / LTILE; ++tile) {
        const int t0 = seg * LSEG_TOK + tile * LTILE;
        {
            v4u xr[7];
#pragma unroll
            for (int rr = 0; rr < 7; ++rr) { const int t = t0 + 4 * tq - 3 + rr;
                xr[rr] = (t >= 0) ? *(const GAS v4u*)(F.XL + (rowb + t) * 1024 + blk * 128 + 8 * cg) : (v4u){0u, 0u, 0u, 0u}; }
#pragma unroll
            for (int i = 0; i < 4; ++i) {
                float o[8];
#pragma unroll
                for (int c = 0; c < 8; ++c) o[c] = cb[c];
#pragma unroll
                for (int j = 0; j < 4; ++j) { const v4u xv = xr[i + j];
                    o[0] += cw[j][0] * bf_lo(xv.x); o[1] += cw[j][1] * bf_hi(xv.x); o[2] += cw[j][2] * bf_lo(xv.y); o[3] += cw[j][3] * bf_hi(xv.y);
                    o[4] += cw[j][4] * bf_lo(xv.z); o[5] += cw[j][5] * bf_hi(xv.z); o[6] += cw[j][6] * bf_lo(xv.w); o[7] += cw[j][7] * bf_hi(xv.w); }
                v4u u; u.x = pk2(o[0], o[1]); u.y = pk2(o[2], o[3]); u.z = pk2(o[4], o[5]); u.w = pk2(o[6], o[7]);
                *(LAS v4u*)(XC + toff(4 * tq + i, cg)) = u;
            }
        }
        __syncthreads();
#pragma unroll 1
        for (int tb = 0; tb < 8; ++tb) {
            f32x4 da = (f32x4){0.f, 0.f, 0.f, 0.f}, dx = da, di = da;
#pragma unroll
            for (int s = 0; s < 4; ++s) { const bf16x8 a = *(const LAS bf16x8*)(XCr + tb * 16 * TS + s * 64); da = MFMA16(a, wa[s], da); dx = MFMA16(a, wx[s], dx); if (s == (w >> 1)) di = MFMA16(a, idf, di); }
            float av[4], bv[4];
#pragma unroll
            for (int r = 0; r < 4; ++r) {
                const float rg = sigmoid_f(da[r] + ba), ig = sigmoid_f(dx[r] + bx);
                const float l2a = m8 * rg;
                av[r] = __builtin_amdgcn_exp2f(l2a);
                const float t2 = 2.0f * 0.6931471805599453f * l2a;
                const float om = (t2 > -0.05f) ? -(t2 * (1.0f + t2 * (0.5f + t2 * (0.16666667f + t2 * 0.041666668f)))) : (1.0f - __builtin_amdgcn_exp2f(2.0f * l2a));
                bv[r] = sqrtf(fmaxf(om, 0.f)) * ig * di[r];
            }
            float P[4], H[4];
            P[0] = av[0]; H[0] = bv[0];
#pragma unroll
            for (int r = 1; r < 4; ++r) { P[r] = av[r] * P[r - 1]; H[r] = av[r] * H[r - 1] + bv[r]; }
            float Pi = P[3], Hi = H[3];
            { const float Pu = __shfl_up(Pi, 16), Hu = __shfl_up(Hi, 16); if (g >= 1) { Hi = Pi * Hu + Hi; Pi = Pi * Pu; } }
            { const float Pu = __shfl_up(Pi, 32), Hu = __shfl_up(Hi, 32); if (g >= 2) { Hi = Pi * Hu + Hi; Pi = Pi * Pu; } }
            float Pe = __shfl_up(Pi, 16), He = __shfl_up(Hi, 16); if (g == 0) { Pe = 1.f; He = 0.f; }
            const float Pt = __shfl(Pi, c16 + 48), Ht = __shfl(Hi, c16 + 48);
            if (PASS2) {
                const float base = Pe * hc + He;
#pragma unroll
                for (int r = 0; r < 4; ++r) { const float hv = P[r] * base + H[r]; const int t = 16 * tb + 4 * g + r, o = 16 * w + c16;
                    *(LAS unsigned short*)(HT + TS * t + 2 * o) = f2bf1(hv); }
            }
            hc = Pt * hc + Ht; ptot *= Pt;
        }
        __syncthreads();
        if (PASS2) {
#pragma unroll
            for (int i = 0; i < 4; ++i) {
                const int tl = 4 * tq + i; const size_t row = rowb + t0 + tl;
                const v4u hv = *(const LAS v4u*)(HT + toff(tl, cg)); const v4u gl = *(const GAS v4u*)(F.GL + row * 1024 + blk * 128 + 8 * cg);
                v4u o; o.x = pk2(bf_lo(hv.x) * bf_lo(gl.x), bf_hi(hv.x) * bf_hi(gl.x)); o.y = pk2(bf_lo(hv.y) * bf_lo(gl.y), bf_hi(hv.y) * bf_hi(gl.y));
                o.z = pk2(bf_lo(hv.z) * bf_lo(gl.z), bf_hi(hv.z) * bf_hi(gl.z)); o.w = pk2(bf_lo(hv.w) * bf_lo(gl.w), bf_hi(hv.w) * bf_hi(gl.w));
                *(GAS v4u*)(F.MIX + row * MIXW + 1024 + blk * 128 + 8 * cg) = o;
            }
        }
    }
    if (!PASS2) { if (g == 0) { f32x2 ph; ph.x = ptot; ph.y = hc; *(GAS f32x2*)(F.LSUM + ((size_t)(b * NLSEG + seg) * 1024 + och) * 2) = ph; } }
    __syncthreads();
}

__device__ __forceinline__ void final_norm(Frame& F) {
    const int gw = F.vcu * NWAVES + F.wave, NGW = F.G * NWAVES;
    f32x4 gv[4];
#pragma unroll
    for (int j = 0; j < 4; ++j) gv[j] = ((const GAS f32x4*)F.norm_out_g)[F.lane + 64 * j];
    for (int m = gw; m < M; m += NGW) {
        GAS f32x4* xr = (GAS f32x4*)(F.out + (size_t)m * DM) + F.lane;
        f32x4 v[4]; float s = 0.f;
#pragma unroll
        for (int j = 0; j < 4; ++j) { v[j] = xr[64 * j]; s += (v[j].x * v[j].x + v[j].y * v[j].y) + (v[j].z * v[j].z + v[j].w * v[j].w); }
        s = wave_sum(s);
        const float r = 1.0f / sqrtf(s * (1.0f / DM) + NORM_EPS);
#pragma unroll
        for (int j = 0; j < 4; ++j) xr[64 * j] = v[j] * r * gv[j];
    }
}

struct Args { const float* in[12]; float* out; unsigned char* ws; int ph_lo, ph_hi, li, pad; };
__global__ void __launch_bounds__(NWAVES * 64, 2) fwd_kernel(Args args) {
    extern __shared__ __attribute__((aligned(16))) unsigned char lds[];
    Frame F;
    F.lds = (LAS unsigned char*)lds;
    F.MISC = (volatile LAS unsigned*)(F.lds + MISC_OFF);
    F.tid = threadIdx.x; F.lane = F.tid & 63; F.wave = __builtin_amdgcn_readfirstlane(F.tid >> 6);
    F.G = gridDim.x; { const int bx = blockIdx.x; F.vcu = (F.G % 8 == 0) ? (bx % 8) * (F.G / 8) + bx / 8 : bx; }
    unsigned char* ws = args.ws;
    F.ctl = (gu32*)(ws + WS_CTL);
    F.x = args.in[0]; F.norm_in_g = args.in[1]; F.w_in = args.in[2]; F.conv_w = args.in[3]; F.conv_b = args.in[4]; F.ga_w = args.in[5]; F.ga_b = args.in[6];
    F.gx_w = args.in[7]; F.gx_b = args.in[8]; F.lam = args.in[9]; F.w_out = args.in[10]; F.norm_out_g = args.in[11]; F.out = args.out;
    F.WIN = (bf16*)(ws + WS_WIN); F.WOUT = (bf16*)(ws + WS_WOUT); F.WAT = (bf16*)(ws + WS_WG); F.WXT = F.WAT + 8 * 16384;
    F.CS = (float*)(ws + WS_CS); F.RROW = (float*)(ws + WS_RROW); F.LSUM = (float*)(ws + WS_LSUM); F.RSUM = (float*)(ws + WS_RSUM);
    F.Q = (bf16*)(ws + WS_Q); F.K = (bf16*)(ws + WS_K); F.V = (bf16*)(ws + WS_V); F.GR = (bf16*)(ws + WS_GR); F.GL = (bf16*)(ws + WS_GL); F.MIX = (bf16*)(ws + WS_MIX);
    F.XB = (bf16*)((unsigned char*)args.out + OUT_XB); F.XL = (bf16*)((unsigned char*)args.out + OUT_XL);
    for (int u = F.tid; u < (LDS_BYTES - LDSCTL_OFF) / 4; u += NWAVES * 64) ((LAS unsigned*)(F.lds + LDSCTL_OFF))[u] = 0u;
    __syncthreads();
    XcdBarrier bar; bar.bar = (unsigned*)(F.ctl + CW_BAR); bar.x = 0; bar.st = nullptr;
    if (N_LAUNCHES != PER_PHASE) bar = xcd_barrier_post((unsigned*)(F.ctl + CW_BAR), F.MISC + 8);
#define GRID_BAR() do { if (N_LAUNCHES != PER_PHASE) xcd_barrier(bar); } while (0)
    const int lo = args.ph_lo, hi = args.ph_hi;
#ifndef PH_MASK
#define PH_MASK 63
#endif
#define IN(k) (((PH_MASK >> (k)) & 1) && lo <= (k) && (k) < hi)
#define BOTH(k) (IN(k) && IN((k) + 1))

    if (IN(0)) { p0_prologue(F); if (BOTH(0)) GRID_BAR(); }

    if (IN(1)) {
        pg8::Gemm g{F.XB, F.WIN, M, NIN, DM}; pg8::StaticOrder S; S.init(M, NIN, F.G, (int)blockIdx.x);
        pg8::EpiProj E{F.Q, F.K, F.V, F.GR, F.XL, F.GL, F.RROW, F.CS};
        pg8::gemm_phase<pg8::EpiProj, pg8::StaticOrder, PG8_ALIGN, PG8_SP2>(F.lds + RING_OFF, g, S, E);
        if (BOTH(1)) GRID_BAR();
    }

    if (IN(2)) {
        for (int u = blockIdx.x; u < BATCH * NH * NRSEG; u += F.G) {
            const int b = u >> 6, h = (u >> 3) & 7, seg = u & 7;
            if (seg < NRSEG - 1) ret_unit<false>(F, b, h, seg);
            if (seg < NLSEG - 1) lru_unit<false>(F, b, h, seg);
        }
        if (BOTH(2)) GRID_BAR();
    }

    if (IN(3)) {
        for (int u = blockIdx.x; u < BATCH * NH * NRSEG; u += F.G) {
            const int b = u >> 6, h = (u >> 3) & 7, seg = u & 7;
#ifndef NO_RET
            ret_unit<true>(F, b, h, seg);
#endif
#ifndef NO_LRU
            lru_unit<true>(F, b, h, seg);
#endif
        }
        if (BOTH(3)) GRID_BAR();
    }

    if (IN(4)) {
        pg8::Gemm g{F.MIX, F.WOUT, M, DM, MIXW}; pg8::StaticOrder S; S.init(M, DM, F.G, (int)blockIdx.x);
        pg8::EpiOut E{F.x, F.out};
        pg8::gemm_phase<pg8::EpiOut, pg8::StaticOrder, PG8_ALIGN, PG8_SP2>(F.lds + RING_OFF, g, S, E);
        if (BOTH(4)) GRID_BAR();
    }

    if (IN(5)) final_norm(F);
#undef IN
#undef BOTH
}

extern "C" void kernel_launch(void* const* d_in, const int* in_sizes, int n_in, void* d_out, int out_size, void* d_ws, size_t ws_size, hipStream_t stream) {
    static int grid = 0;
    if (grid == 0) {
        if (n_in != 12 || in_sizes[0] != M * DM || out_size != M * DM || ws_size < WS_END) { fprintf(stderr, "kernel_launch: unexpected shapes: n_in %d in0 %d out %d ws %zu (need %zu)\n", n_in, n_in > 0 ? in_sizes[0] : -1, out_size, ws_size, (size_t)WS_END); grid = -1; return; }
        int dev = 0, cus = 0, per_cu = 0;
        if (hipGetDevice(&dev) != hipSuccess || hipDeviceGetAttribute(&cus, hipDeviceAttributeMultiprocessorCount, dev) != hipSuccess) { fprintf(stderr, "kernel_launch: device query failed\n"); grid = -1; return; }
        if (hipFuncSetAttribute((const void*)fwd_kernel, hipFuncAttributeMaxDynamicSharedMemorySize, LDS_BYTES) != hipSuccess) { fprintf(stderr, "kernel_launch: hipFuncSetAttribute failed\n"); grid = -1; return; }
        if (hipOccupancyMaxActiveBlocksPerMultiprocessor(&per_cu, (const void*)fwd_kernel, NWAVES * 64, LDS_BYTES) != hipSuccess || per_cu < 1) { fprintf(stderr, "kernel_launch: occupancy query reports %d blocks per CU\n", per_cu); }
        (void)hipGetLastError();
        grid = cus;
        if (grid > 256) grid = 256;
    }
    if (grid < 0) return;
    if (hipMemsetAsync((char*)d_ws + WS_CTL, 0, CTL_ZERO_BYTES, stream) != hipSuccess) { fprintf(stderr, "kernel_launch: memset failed\n"); return; }
    Args a{};
    for (int i = 0; i < 12; ++i) a.in[i] = (const float*)d_in[i];
    a.out = (float*)d_out; a.ws = (unsigned char*)d_ws;
    const int nl = (N_LAUNCHES == PER_PHASE) ? PER_PHASE : 1;
    for (int li = 0; li < nl; ++li) {
        a.ph_lo = (N_LAUNCHES == PER_PHASE) ? li : 0; a.ph_hi = (N_LAUNCHES == PER_PHASE) ? li + 1 : PER_PHASE; a.li = li;
        hipLaunchKernelGGL(fwd_kernel, dim3(grid), dim3(NWAVES * 64), LDS_BYTES, stream, a);
        const hipError_t le = hipPeekAtLastError();
        if (le != hipSuccess) { fprintf(stderr, "kernel_launch: launch %d failed: %s\n", li, hipGetErrorName(le)); break; }
    }
}
```
